# Optimizing an MI355X kernel written in HIP

```python
import jax
import jax.numpy as jnp
from jax import lax
import numpy as np

D_MODEL = 1024
BATCH = 2
SEQ = 8192
DEPTH = 2
DEC_BATCH = 32
DEC_SEQ = 8
PAST_LEN = 8192
PAGE_SIZE = 128

N_A_LAYERS = DEPTH // 2
N_B_LAYERS = DEPTH - N_A_LAYERS
MIX_WIDTH = D_MODEL
MEM_HEADS = 4
MEM_HEAD_DIM = 64
MEM_WIDTH = MEM_HEADS * MEM_HEAD_DIM
N_MEM = 256
MAIN_WIDTH = MIX_WIDTH - MEM_WIDTH
RET_HEADS = 6
RET_HEAD_DIM = MAIN_WIDTH // RET_HEADS
RET_CHUNK = 128
DIL_PAIRS = ((128, 1), (512, 4), (2048, 16))
GROUP_HEADS = 4
DIL_HEADS = GROUP_HEADS * len(DIL_PAIRS)
DIL_HEAD_DIM = MAIN_WIDTH // DIL_HEADS
FFN_HIDDEN = -((-8 * D_MODEL) // (3 * 256)) * 256
ROPE_THETA = 10000.0
LN_EPS = 1e-5
ALPHA = (2 * DEPTH) ** 0.25
BETA = (8 * DEPTH) ** -0.25

kernel_name = 'yoco_retention_dilated_attn_step'


def layer_norm(x, g, b):
    xf = x.astype(jnp.float32)
    mu = jnp.mean(xf, -1, keepdims=True)
    var = jnp.mean(jnp.square(xf - mu), -1, keepdims=True)
    y = (xf - mu) * lax.rsqrt(var + LN_EPS) * g.astype(jnp.float32) + b.astype(jnp.float32)
    return y.astype(x.dtype)


def deepnorm_residual(x, h, g, b):
    return layer_norm(ALPHA * x + h, g, b)


def swiglu_ffn(x, w_in, w_out):
    gate, up = jnp.split(x @ w_in, 2, axis=-1)
    return (jax.nn.silu(gate) * up) @ w_out


def rope(x, pos):
    d = x.shape[-1]
    inv = ROPE_THETA ** (-jnp.arange(0, d, 2, dtype=jnp.float32) / d)
    ang = pos[:, None] * inv[None, :]
    cos = jnp.cos(ang)[:, None, :]
    sin = jnp.sin(ang)[:, None, :]
    xf = x.astype(jnp.float32)
    x1, x2 = xf[..., : d // 2], xf[..., d // 2:]
    return jnp.concatenate([x1 * cos - x2 * sin, x2 * cos + x1 * sin], -1).astype(x.dtype)


def project_memory_kv(mem, w):
    b, n, _ = mem.shape
    return (mem @ w).reshape(b, n, 2, MEM_HEADS, MEM_HEAD_DIM)


def memory_attention(q, mem_kv):
    b, s = q.shape[0], q.shape[1]
    sc = jnp.einsum('bshd,bnhd->bhsn', q, mem_kv[:, :, 0]).astype(jnp.float32) * MEM_HEAD_DIM ** -0.5
    p = jax.nn.softmax(sc, axis=-1).astype(q.dtype)
    o = jnp.einsum('bhsn,bnhd->bshd', p, mem_kv[:, :, 1])
    return o.reshape(b, s, MEM_WIDTH)


def retention_log_decay():
    return jnp.log1p(-jnp.exp2(-5.0 - jnp.arange(RET_HEADS, dtype=jnp.float32)))


def retention_inputs(x, w_in, pos):
    b, s, _ = x.shape
    q, k, v, gate, qm = jnp.split(x @ w_in, [MAIN_WIDTH, 2 * MAIN_WIDTH, 3 * MAIN_WIDTH, 4 * MAIN_WIDTH], axis=-1)
    heads = lambda t: t.reshape(b, s, RET_HEADS, RET_HEAD_DIM)
    q = rope(heads(q), pos)
    k = rope(heads(k), pos) * RET_HEAD_DIM ** -0.5
    tr = lambda t: t.astype(jnp.float32).transpose(0, 2, 1, 3)
    return tr(q), tr(k), tr(heads(v)), gate, qm.reshape(b, s, MEM_HEADS, MEM_HEAD_DIM)


def retention_chunk(q, k, v, state, log_g):
    c = q.shape[2]
    i = jnp.arange(c, dtype=jnp.float32)
    diff = i[:, None] - i[None, :]
    lg = log_g[:, None, None]
    decay = jnp.where(diff >= 0, jnp.exp(jnp.maximum(diff, 0.0) * lg), 0.0)
    inner = jnp.einsum('bhqk,bhkv->bhqv', jnp.einsum('bhqd,bhkd->bhqk', q, k) * decay, v)
    cross = jnp.einsum('bhqd,bhdv->bhqv', q, state) * jnp.exp((i[None, :, None] + 1.0) * lg)
    k_dec = k * jnp.exp((c - 1.0 - i)[None, :, None] * lg)
    new_state = jnp.exp(c * lg) * state + jnp.einsum('bhkd,bhkv->bhdv', k_dec, v)
    return inner + cross, new_state


def retention_prompt(q, k, v, log_g):
    b, h, s, dk = q.shape
    dv = v.shape[-1]
    nc = s // RET_CHUNK
    blocks = lambda t: t.reshape(b, h, nc, RET_CHUNK, t.shape[-1]).transpose(2, 0, 1, 3, 4)

    def step(state, qkv):
        qc, kc, vc = qkv
        o, state = retention_chunk(qc, kc, vc, state, log_g)
        return state, o

    state0 = jnp.zeros((b, h, dk, dv), jnp.float32)
    state, o = lax.scan(step, state0, (blocks(q), blocks(k), blocks(v)))
    return o.transpose(1, 2, 0, 3, 4).reshape(b, h, s, dv), state


def retention_output(o, gate):
    b, h, s, dv = o.shape
    mu = jnp.mean(o, -1, keepdims=True)
    var = jnp.mean(jnp.square(o - mu), -1, keepdims=True)
    on = ((o - mu) * lax.rsqrt(var + LN_EPS)).transpose(0, 2, 1, 3).reshape(b, s, h * dv)
    return jax.nn.silu(gate) * on.astype(gate.dtype)


def dilated_inputs(x, w_in, pos):
    b, s, _ = x.shape
    q, qm = jnp.split(x @ w_in, [MAIN_WIDTH], axis=-1)
    q = rope(q.reshape(b, s, DIL_HEADS, DIL_HEAD_DIM), pos)
    return q, qm.reshape(b, s, MEM_HEADS, MEM_HEAD_DIM)


def shared_kv(x, w_kv, pos):
    b, s, _ = x.shape
    kv = (x @ w_kv).reshape(b, s, 2, DIL_HEADS, DIL_HEAD_DIM)
    return jnp.stack([rope(kv[:, :, 0], pos), kv[:, :, 1]], axis=2)


def dilated_prompt(q, k, v, window, dil):
    b, s, hg, d = q.shape
    blk = window // dil
    m = s // dil
    nb = -(-m // blk)
    mp = nb * blk

    def to_blocks(t):
        t = t.reshape(b, m, dil, hg, d).transpose(0, 2, 1, 3, 4)
        t = jnp.pad(t, ((0, 0), (0, 0), (0, mp - m), (0, 0), (0, 0)))
        return t.reshape(b, dil, nb, blk, hg, d)

    def with_prev(t):
        prev = jnp.concatenate([jnp.zeros_like(t[:, :, :1]), t[:, :, :-1]], axis=2)
        return jnp.concatenate([prev, t], axis=3)

    qb = to_blocks(q)
    kk = with_prev(to_blocks(k))
    vv = with_prev(to_blocks(v))
    sc = jnp.einsum('brcqhd,brckhd->brchqk', qb, kk).astype(jnp.float32) * d ** -0.5
    qi = jnp.arange(blk)[:, None]
    kj = jnp.arange(2 * blk)[None, :]
    delta = qi + blk - kj
    band = (delta >= 0) & (delta <= blk)
    valid = band[None] & ((jnp.arange(nb)[:, None, None] > 0) | (kj >= blk)[None])
    sc = jnp.where(valid[:, None], sc, -jnp.inf)
    lse = jax.nn.logsumexp(sc, axis=-1)
    p = jnp.exp(sc - lse[..., None]).astype(v.dtype)
    o = jnp.einsum('brchqk,brckhd->brcqhd', p, vv)

    def from_blocks(t):
        t = t.reshape((b, dil, mp) + t.shape[4:])[:, :, :m]
        t = jnp.swapaxes(t, 1, 2)
        return t.reshape((b, s) + t.shape[3:])

    return from_blocks(o), from_blocks(lse.transpose(0, 1, 2, 4, 3))


def dilated_sample(q, kv_all, window, dil, n_buf):
    t = q.shape[1]
    d = q.shape[-1]
    n = window // dil + 1
    idx = n_buf + jnp.arange(t)[:, None] - dil * jnp.arange(n)[None, :]
    valid = idx >= 0
    kg = kv_all[:, jnp.maximum(idx, 0)]
    sc = jnp.einsum('bthd,btjhd->bhtj', q, kg[:, :, :, 0]).astype(jnp.float32) * d ** -0.5
    sc = jnp.where(valid[None, None], sc, -jnp.inf)
    lse = jax.nn.logsumexp(sc, axis=-1)
    p = jnp.exp(sc - lse[..., None]).astype(q.dtype)
    o = jnp.einsum('bhtj,btjhd->bthd', p, kg[:, :, :, 1])
    return o, lse.transpose(0, 2, 1)


def combine_groups(outs, lses):
    o = jnp.stack(outs, axis=2)
    w = jax.nn.softmax(jnp.stack(lses, axis=2), axis=2)
    o = o * w[..., None].astype(o.dtype)
    return o.reshape(o.shape[0], o.shape[1], -1)


def setup_inputs(seed: int = 0) -> dict:
    key = jax.random.key(seed)
    ks = jax.random.split(key, 20)
    nrm = lambda k, shape, scale=1.0: scale * jax.random.normal(k, shape, jnp.float32)
    d = D_MODEL
    return {
        'x_prompt': nrm(ks[0], (BATCH, SEQ, d)),
        'x_sample': nrm(ks[1], (DEC_BATCH, DEC_SEQ, d)),
        'mem_prompt': nrm(ks[2], (BATCH, N_MEM, d)),
        'cache_mem_kv': nrm(ks[3], (DEPTH, DEC_BATCH, N_MEM, 2, MEM_HEADS, MEM_HEAD_DIM)),
        'state_ret': nrm(ks[4], (N_A_LAYERS, DEC_BATCH, RET_HEADS, RET_HEAD_DIM, RET_HEAD_DIM)),
        'cache_win_kv_g1': nrm(ks[5], (DEC_BATCH, min(DIL_PAIRS[0][0], PAST_LEN), 2, GROUP_HEADS, DIL_HEAD_DIM)),
        'cache_win_kv_g2': nrm(ks[6], (DEC_BATCH, min(DIL_PAIRS[1][0], PAST_LEN), 2, GROUP_HEADS, DIL_HEAD_DIM)),
        'cache_win_kv_g3': nrm(ks[7], (DEC_BATCH, min(DIL_PAIRS[2][0], PAST_LEN), 2, GROUP_HEADS, DIL_HEAD_DIM)),
        'w_in_a': nrm(ks[8], (N_A_LAYERS, d, 4 * MAIN_WIDTH + MEM_WIDTH), d ** -0.5),
        'w_in_b': nrm(ks[9], (N_B_LAYERS, d, MAIN_WIDTH + MEM_WIDTH), d ** -0.5),
        'w_out': nrm(ks[10], (DEPTH, MIX_WIDTH, d), BETA * MIX_WIDTH ** -0.5),
        'w_kv_shared': nrm(ks[11], (d, 2 * MAIN_WIDTH), d ** -0.5),
        'w_mem_kv': nrm(ks[12], (DEPTH, d, 2 * MEM_WIDTH), d ** -0.5),
        'ln_mix_g': 1.0 + nrm(ks[13], (DEPTH, d), 0.02),
        'ln_mix_b': nrm(ks[14], (DEPTH, d), 0.02),
        'ln_ffn_g': 1.0 + nrm(ks[15], (DEPTH, d), 0.02),
        'ln_ffn_b': nrm(ks[16], (DEPTH, d), 0.02),
        'w_ffn_in': nrm(ks[17], (DEPTH, d, 2 * FFN_HIDDEN), d ** -0.5),
        'w_ffn_out': nrm(ks[18], (DEPTH, FFN_HIDDEN, d), BETA * FFN_HIDDEN ** -0.5),
    }


def reference(x_prompt, x_sample, mem_prompt, cache_mem_kv, state_ret, cache_win_kv_g1,
              cache_win_kv_g2, cache_win_kv_g3, w_in_a, w_in_b, w_out, w_kv_shared, w_mem_kv,
              ln_mix_g, ln_mix_b, ln_ffn_g, ln_ffn_b, w_ffn_in, w_ffn_out):
    s = x_prompt.shape[1]
    t = x_sample.shape[1]
    pos_p = jnp.arange(s, dtype=jnp.float32)
    pos_s = PAST_LEN + jnp.arange(t, dtype=jnp.float32)
    log_g = retention_log_decay()
    win_caches = (cache_win_kv_g1, cache_win_kv_g2, cache_win_kv_g3)
    xp, xs = x_prompt, x_sample
    ret_p, ret_s, mem_kv_p = [], [], []
    for l in range(DEPTH):
        mkv_p = project_memory_kv(mem_prompt, w_mem_kv[l])
        mkv_s = cache_mem_kv[l]
        mem_kv_p.append(mkv_p)
        if l < N_A_LAYERS:
            q, k, v, gate, qm = retention_inputs(xp, w_in_a[l], pos_p)
            o, st = retention_prompt(q, k, v, log_g)
            mix_p = jnp.concatenate([retention_output(o, gate), memory_attention(qm, mkv_p)], -1)
            ret_p.append(st.astype(xp.dtype))
            q, k, v, gate, qm = retention_inputs(xs, w_in_a[l], pos_s)
            o, st = retention_chunk(q, k, v, state_ret[l].astype(jnp.float32), log_g)
            mix_s = jnp.concatenate([retention_output(o, gate), memory_attention(qm, mkv_s)], -1)
            ret_s.append(st.astype(state_ret.dtype))
        else:
            if l == N_A_LAYERS:
                kv_p = shared_kv(xp, w_kv_shared, pos_p)
                kv_s = shared_kv(xs, w_kv_shared, pos_s)
                win_p, win_s, kv_all_s = [], [], []
                for g, (window, _) in enumerate(DIL_PAIRS):
                    hs = slice(g * GROUP_HEADS, (g + 1) * GROUP_HEADS)
                    win_p.append(kv_p[:, s - min(window, s):, :, hs])
                    kva = jnp.concatenate([win_caches[g], kv_s[:, :, :, hs]], axis=1)
                    kv_all_s.append(kva)
                    win_s.append(kva[:, kva.shape[1] - min(window, kva.shape[1]):])
            bl = l - N_A_LAYERS
            q_p, qm_p = dilated_inputs(xp, w_in_b[bl], pos_p)
            q_s, qm_s = dilated_inputs(xs, w_in_b[bl], pos_s)
            outs_p, lses_p, outs_s, lses_s = [], [], [], []
            for g, (window, dil) in enumerate(DIL_PAIRS):
                hs = slice(g * GROUP_HEADS, (g + 1) * GROUP_HEADS)
                o, lse = dilated_prompt(q_p[:, :, hs], kv_p[:, :, 0, hs], kv_p[:, :, 1, hs], window, dil)
                outs_p.append(o)
                lses_p.append(lse)
                o, lse = dilated_sample(q_s[:, :, hs], kv_all_s[g], window, dil, win_caches[g].shape[1])
                outs_s.append(o)
                lses_s.append(lse)
            mix_p = jnp.concatenate([combine_groups(outs_p, lses_p), memory_attention(qm_p, mkv_p)], -1)
            mix_s = jnp.concatenate([combine_groups(outs_s, lses_s), memory_attention(qm_s, mkv_s)], -1)
        xp = deepnorm_residual(xp, mix_p @ w_out[l], ln_mix_g[l], ln_mix_b[l])
        xs = deepnorm_residual(xs, mix_s @ w_out[l], ln_mix_g[l], ln_mix_b[l])
        xp = deepnorm_residual(xp, swiglu_ffn(xp, w_ffn_in[l], w_ffn_out[l]), ln_ffn_g[l], ln_ffn_b[l])
        xs = deepnorm_residual(xs, swiglu_ffn(xs, w_ffn_in[l], w_ffn_out[l]), ln_ffn_g[l], ln_ffn_b[l])
    return (xp, xs, jnp.stack(ret_p), jnp.stack(ret_s), jnp.stack(mem_kv_p),
            win_p[0], win_p[1], win_p[2], win_s[0], win_s[1], win_s[2])
```

```cpp
#include <hip/hip_runtime.h>
#include <hip/hip_cooperative_groups.h>
#include <cstdio>
#include <cstdint>
#include <cmath>
namespace cg = cooperative_groups;
namespace pg8 {
#define PG8_LAS __attribute__((address_space(3)))
typedef unsigned short bf16_t;
typedef short bf16x8 __attribute__((ext_vector_type(8)));
typedef float f32x4 __attribute__((ext_vector_type(4)));
typedef unsigned u32x4 __attribute__((ext_vector_type(4)));
constexpr int BM = 256, BK = 64, HALF = 128, HTB = HALF * BK * 2  , STAGE_BYTES = 8 * HTB, NXCD = 8, WGM = 8;

__host__ __device__ __forceinline__ int lds_byte(int r, int c) { const int st = (r >> 4) * 2 + (c >> 5), rr = r & 15, cc = c & 31, ob = rr * 64 + cc * 2; return st * 1024 + (ob ^ (((ob >> 9) & 1) << 5)); }
__host__ __device__ __forceinline__ void stage_rc(int b, int& R, int& C) { const int st = b / 1024, sb = b % 1024, swz = sb ^ (((sb >> 9) & 1) << 5); R = (st >> 1) * 16 + swz / 64; C = (st & 1) * 32 + (swz % 64) / 2; }
__host__ __device__ __forceinline__ int perm32(int rho) { const int n = rho >> 4, i = rho & 15; return 8 * (i >> 2) + 4 * n + (i & 3); }

struct Unit { int pm, pn; };
struct Gemm { const bf16_t* A; const bf16_t* Bt; int M, N, K; };

struct StaticOrder {
    int nM, nN, nwg, G, c;
    __host__ __device__ void init(int M, int N, int G_, int c_) { nM = M / BM; nN = N / BM; nwg = nM * nN; G = G_; c = c_; }
    __host__ __device__ bool next(int i, Unit& u) const {
        const long L = (long)i * G + c; if (L >= nwg) return false;
        int wgid = (int)L; { const int q = nwg / NXCD, r = nwg % NXCD, xcd = wgid % NXCD, off = wgid / NXCD; wgid = (xcd < r ? xcd * (q + 1) : r * (q + 1) + (xcd - r) * q) + off; }
        const int nig = WGM * nN, gid = wgid / nig, fm = gid * WGM, gsz = (nM - fm) < WGM ? (nM - fm) : WGM;
        u.pm = fm + ((wgid % nig) % gsz); u.pn = (wgid % nig) / gsz; return true;
    }
    __device__ __forceinline__ void a_ready(const Unit&) const {}
    __device__ __forceinline__ void done(const Unit&) const {}
};
__device__ __forceinline__ unsigned cvt_pk_bf16(float lo, float hi) { unsigned r; asm volatile("v_cvt_pk_bf16_f32 %0, %1, %2" : "=v"(r) : "v"(lo), "v"(hi)); return r; }
template <class Epi, class Sched, bool ALIGN_EPI = false, bool SP2 = false>
__device__ __forceinline__ void gemm_phase(PG8_LAS unsigned char* lds, const Gemm g, const Sched& S, const Epi& E) {
    const int tid = threadIdx.x, wid = __builtin_amdgcn_readfirstlane(tid >> 6), lane = tid & 63, wr = wid >> 2, wc = wid & 3, fr = lane & 15, fq = lane >> 4;
    const int K = g.K, nt = K / BK;
    unsigned voffA[2], voffB[2];
#pragma unroll
    for (int i = 0; i < 2; ++i) { int R, C; stage_rc(tid * 16 + i * 8192, R, C); const int Rb = Epi::PERM ? ((R & ~31) + perm32(R & 31)) : R;
        voffA[i] = (unsigned)(R * K + C) * 2u; voffB[i] = (unsigned)(Rb * K + C) * 2u; }
    const size_t kstep = (size_t)(BK * 2);
    const size_t hstep = (size_t)HALF * K * 2;
    const size_t tstep = 2 * hstep;
    const unsigned ldsw = (unsigned)wid * 1024u;
    const int aoff = lds_byte(wr * 64 + fr, fq * 8), boff = lds_byte(wc * 32 + fr, fq * 8);
#define PG8_SA(b, h) (((b) * 2 + (h)) * HTB)
#define PG8_SB(b, h) ((4 + (b) * 2 + (h)) * HTB)
#define PG8_STAGE(bufoff, gbase, voff) do { _Pragma("unroll") for (int _i = 0; _i < 2; ++_i) \
        __builtin_amdgcn_global_load_lds((const unsigned*)((const char*)(gbase) + (voff)[_i]), (PG8_LAS unsigned*)(lds + (bufoff) + ldsw + _i * 8192), 16, 0, 0); } while (0)
#define PG8_LDA(dst, b, h) do { _Pragma("unroll") for (int m = 0; m < 4; ++m) _Pragma("unroll") for (int k = 0; k < 2; ++k) dst[m][k] = *(const PG8_LAS bf16x8*)(lds + PG8_SA(b, h) + aoff + m * 2048 + k * 1024); } while (0)
#define PG8_LDB(dst, b, h) do { _Pragma("unroll") for (int n = 0; n < 2; ++n) _Pragma("unroll") for (int k = 0; k < 2; ++k) dst[n][k] = *(const PG8_LAS bf16x8*)(lds + PG8_SB(b, h) + boff + n * 2048 + k * 1024); } while (0)
#define PG8_MMA(ai, bj, At, Bt) do { __builtin_amdgcn_s_setprio(1); _Pragma("unroll") for (int m = 0; m < 4; ++m) _Pragma("unroll") for (int n = 0; n < 2; ++n) _Pragma("unroll") for (int k = 0; k < 2; ++k) \
        acc[ai][bj][m][n] = __builtin_amdgcn_mfma_f32_16x16x32_bf16(Bt[n][k], At[m][k], acc[ai][bj][m][n], 0, 0, 0); __builtin_amdgcn_s_setprio(0); } while (0)
#define PG8_WAIT_V(n) asm volatile("s_waitcnt vmcnt(" #n ")" ::: "memory")
#define PG8_WAIT_L(n) asm volatile("s_waitcnt lgkmcnt(" #n ")" ::: "memory")
#define PG8_BAR __builtin_amdgcn_s_barrier()
#define PG8_SCHED __builtin_amdgcn_sched_barrier(0)
    Unit cur, nxt; int ui = 0;
    if (!S.next(0, cur)) return;
    f32x4 acc[2][2][4][2];
#pragma unroll
    for (int a = 0; a < 2; ++a)
#pragma unroll
        for (int b = 0; b < 2; ++b)
#pragma unroll
            for (int m = 0; m < 4; ++m)
#pragma unroll
                for (int n = 0; n < 2; ++n) acc[a][b][m][n] = (f32x4){0.f, 0.f, 0.f, 0.f};
    bf16x8 At[4][2], B0[2][2], B1[2][2];
    const char* cA = (const char*)g.A + (size_t)cur.pm * tstep; const char* cB = (const char*)g.Bt + (size_t)cur.pn * tstep;
    S.a_ready(cur);
    if constexpr (SP2) {
        PG8_STAGE(PG8_SB(0, 0), cB, voffB); PG8_STAGE(PG8_SB(0, 1), cB + hstep, voffB); PG8_STAGE(PG8_SA(0, 0), cA, voffA); PG8_STAGE(PG8_SA(0, 1), cA + hstep, voffA);
        if (wr == 1) PG8_BAR;
        PG8_WAIT_V(2); PG8_BAR;
        PG8_STAGE(PG8_SB(1, 0), cB + kstep, voffB); PG8_STAGE(PG8_SA(1, 0), cA + kstep, voffA); PG8_STAGE(PG8_SB(1, 1), cB + hstep + kstep, voffB);
        PG8_WAIT_V(6); PG8_BAR;
    } else {
        PG8_STAGE(PG8_SB(0, 0), cB, voffB); PG8_STAGE(PG8_SA(0, 0), cA, voffA); PG8_STAGE(PG8_SB(0, 1), cB + hstep, voffB); PG8_STAGE(PG8_SA(0, 1), cA + hstep, voffA);
        if (wr == 1) PG8_BAR;
        PG8_WAIT_V(4); PG8_BAR;
        PG8_STAGE(PG8_SB(1, 0), cB + kstep, voffB); PG8_STAGE(PG8_SA(1, 0), cA + kstep, voffA); PG8_STAGE(PG8_SB(1, 1), cB + hstep + kstep, voffB);
        PG8_WAIT_V(6); PG8_BAR;
    }
    for (;;) {
        const bool has_next = S.next(ui + 1, nxt);
        const char* nA = has_next ? (const char*)g.A + (size_t)nxt.pm * tstep : cA; const char* nB = has_next ? (const char*)g.Bt + (size_t)nxt.pn * tstep : cB;
        for (int t = 0; t < nt; t += 2) {
            const bool last = (t == nt - 2);
            const char* a1 = cA + (size_t)(t + 1) * kstep;
            const char* a2 = last ? nA : cA + (size_t)(t + 2) * kstep; const char* b2 = last ? nB : cB + (size_t)(t + 2) * kstep;
            const char* a3 = a2 + kstep; const char* b3 = b2 + kstep;
            if (last && has_next) S.a_ready(nxt);
            if constexpr (SP2) {
            PG8_LDB(B0, 0, 0); PG8_LDB(B1, 0, 1); PG8_SCHED; PG8_LDA(At, 0, 0); PG8_STAGE(PG8_SA(1, 1), a1 + hstep, voffA);
            PG8_WAIT_V(8); PG8_WAIT_L(0); PG8_BAR; PG8_MMA(0, 0, At, B0); PG8_MMA(0, 1, At, B1); PG8_BAR; PG8_SCHED;
            PG8_LDA(At, 0, 1); PG8_STAGE(PG8_SB(0, 0), b2, voffB); PG8_STAGE(PG8_SB(0, 1), b2 + hstep, voffB); PG8_STAGE(PG8_SA(0, 0), a2, voffA);
            PG8_WAIT_V(8); PG8_WAIT_L(0); PG8_BAR; PG8_MMA(1, 0, At, B0); PG8_MMA(1, 1, At, B1); PG8_BAR; PG8_SCHED;
            PG8_LDB(B0, 1, 0); PG8_LDB(B1, 1, 1); PG8_SCHED; PG8_LDA(At, 1, 0); PG8_STAGE(PG8_SA(0, 1), a2 + hstep, voffA);
            PG8_WAIT_V(8); PG8_WAIT_L(0); PG8_BAR; PG8_MMA(0, 0, At, B0); PG8_MMA(0, 1, At, B1); PG8_BAR; PG8_SCHED;
            PG8_LDA(At, 1, 1); PG8_STAGE(PG8_SB(1, 0), b3, voffB); PG8_STAGE(PG8_SB(1, 1), b3 + hstep, voffB); PG8_STAGE(PG8_SA(1, 0), a3, voffA);
            PG8_WAIT_V(8); PG8_WAIT_L(0); PG8_BAR; PG8_MMA(1, 0, At, B0); PG8_MMA(1, 1, At, B1); PG8_BAR; PG8_SCHED;
            } else {
            PG8_LDB(B0, 0, 0); PG8_SCHED; PG8_LDA(At, 0, 0); PG8_STAGE(PG8_SA(1, 1), a1 + hstep, voffA);
            PG8_WAIT_L(8); PG8_BAR; PG8_WAIT_L(0); PG8_MMA(0, 0, At, B0); PG8_BAR; PG8_SCHED;
            PG8_LDB(B1, 0, 1); PG8_STAGE(PG8_SB(0, 0), b2, voffB);
            PG8_BAR; PG8_WAIT_L(0); PG8_MMA(0, 1, At, B1); PG8_BAR;
            PG8_LDA(At, 0, 1); PG8_STAGE(PG8_SA(0, 0), a2, voffA);
            PG8_BAR; PG8_WAIT_L(0); PG8_MMA(1, 0, At, B0); PG8_BAR; PG8_SCHED;
            PG8_STAGE(PG8_SB(0, 1), b2 + hstep, voffB);
            PG8_WAIT_V(6); PG8_BAR; PG8_MMA(1, 1, At, B1); PG8_BAR;
            PG8_LDB(B0, 1, 0); PG8_SCHED; PG8_LDA(At, 1, 0); PG8_STAGE(PG8_SA(0, 1), a2 + hstep, voffA);
            PG8_WAIT_L(8); PG8_BAR; PG8_WAIT_L(0); PG8_MMA(0, 0, At, B0); PG8_BAR; PG8_SCHED;
            PG8_LDB(B1, 1, 1); PG8_STAGE(PG8_SB(1, 0), b3, voffB);
            PG8_BAR; PG8_WAIT_L(0); PG8_MMA(0, 1, At, B1); PG8_BAR;
            PG8_LDA(At, 1, 1); PG8_STAGE(PG8_SA(1, 0), a3, voffA);
            PG8_BAR; PG8_WAIT_L(0); PG8_MMA(1, 0, At, B0); PG8_BAR; PG8_SCHED;
            PG8_STAGE(PG8_SB(1, 1), b3 + hstep, voffB);
            PG8_WAIT_V(6); PG8_BAR; PG8_MMA(1, 1, At, B1); PG8_BAR;
            }
        }
        if constexpr (ALIGN_EPI) { if (wr == 0) PG8_BAR; }
        if constexpr (!Epi::AFTER_DRAIN) { E(acc, cur, wr, wc, fr, fq); S.done(cur); }
        if (!has_next) break;
#pragma unroll
        for (int a = 0; a < 2; ++a)
#pragma unroll
            for (int b = 0; b < 2; ++b)
#pragma unroll
                for (int m = 0; m < 4; ++m)
#pragma unroll
                    for (int n = 0; n < 2; ++n) acc[a][b][m][n] = (f32x4){0.f, 0.f, 0.f, 0.f};
        cur = nxt; cA = nA; cB = nB; ++ui;
        if constexpr (ALIGN_EPI) { if (wr == 1) PG8_BAR; }
    }
    PG8_WAIT_V(0);
    if constexpr (!ALIGN_EPI) { if (wr == 0) PG8_BAR; }
    PG8_BAR;
    if constexpr (Epi::AFTER_DRAIN) { E.fused(acc, cur, wr, wc, fr, fq, lds, wid, lane); S.done(cur); }
#undef PG8_SA
#undef PG8_SB
#undef PG8_STAGE
#undef PG8_LDA
#undef PG8_LDB
#undef PG8_MMA
#undef PG8_WAIT_V
#undef PG8_WAIT_L
#undef PG8_BAR
#undef PG8_SCHED
}
}

#define DI __device__ __forceinline__
#define LAS __attribute__((address_space(3)))
typedef unsigned short bf16;
typedef short bf16x8 __attribute__((ext_vector_type(8)));
typedef short s16x4 __attribute__((ext_vector_type(4)));
typedef float f32x4 __attribute__((ext_vector_type(4)));
typedef float f32x2 __attribute__((ext_vector_type(2)));
typedef unsigned u32x4 __attribute__((ext_vector_type(4)));
typedef unsigned u32x2 __attribute__((ext_vector_type(2)));

constexpr int DM = 1024, SEQ = 8192, TP = 2 * SEQ, TS = 256, TT = TP + TS;
constexpr int FF = 2816, N_INA = 3328, N_KVB = 2560, N_FFIN = 5632;
constexpr float LN_EPS = 1e-5f;
constexpr float ALPHA = 1.41421356237309515f;
constexpr int NTHR = 512;
constexpr int LDS_BYTES = 147456;

constexpr size_t O_YP = 0, O_YS = 16777216, O_STP = 17039360, O_STS = 17235968, O_MKV = 20381696,
                 O_W1P = 20905984, O_W2P = 21037056, O_W3P = 21561344, O_W1S = 23658496, O_W2S = 25755648, O_W3S = 34144256;
__host__ __device__ constexpr size_t o_winp(int g) { return g == 0 ? O_W1P : (g == 1 ? O_W2P : O_W3P); }
__host__ __device__ constexpr size_t o_wins(int g) { return g == 0 ? O_W1S : (g == 1 ? O_W2S : O_W3S); }

constexpr size_t al4k(size_t x) { return (x + 4095) & ~(size_t)4095; }
constexpr size_t WS_WINA = 0;
constexpr size_t WS_WMKV = WS_WINA + al4k((size_t)N_INA * DM * 2);
constexpr size_t WS_WOUT = WS_WMKV + al4k((size_t)2 * 512 * DM * 2);
constexpr size_t WS_WFIN = WS_WOUT + al4k((size_t)2 * DM * DM * 2);
constexpr size_t WS_WFOUT = WS_WFIN + al4k((size_t)2 * N_FFIN * DM * 2);
constexpr size_t WS_WKVB = WS_WFOUT + al4k((size_t)2 * DM * FF * 2);
constexpr size_t WS_ROPE = WS_WKVB + al4k((size_t)N_KVB * DM * 2);
constexpr size_t WS_XB = WS_ROPE + al4k((size_t)8200 * 64 * 8);
constexpr size_t WS_MEMB = WS_XB + al4k((size_t)TT * DM * 2);
constexpr size_t WS_XR = WS_MEMB + al4k((size_t)512 * DM * 2);
constexpr size_t WS_MIX = WS_XR + al4k((size_t)TT * DM * 4);
constexpr size_t WS_QM = WS_MIX + al4k((size_t)TT * DM * 2);
constexpr size_t WS_LSE = WS_QM + al4k((size_t)TT * 256 * 2);
constexpr size_t WS_MK = WS_LSE + al4k((size_t)TT * 12 * 4);
constexpr size_t WS_MVT = WS_MK + al4k((size_t)2 * 2 * 4 * 256 * 64 * 2);
constexpr size_t WS_QDS = WS_MVT + al4k((size_t)2 * 2 * 4 * 256 * 64 * 2);
constexpr size_t WS_TMP = WS_QDS + al4k((size_t)TS * 768 * 4);
constexpr size_t SZ_TOK768 = al4k((size_t)TT * 768 * 2), SZ_HT = al4k((size_t)12 * 128 * 8192 * 2);
constexpr size_t WS_Q = WS_TMP, WS_K = WS_Q + SZ_TOK768, WS_V = WS_K + SZ_TOK768, WS_G = WS_V + SZ_TOK768;
constexpr size_t WS_KDT = WS_G + SZ_TOK768, WS_VT = WS_KDT + SZ_HT, WS_U = WS_VT + SZ_HT, WS_ST = WS_U + al4k((size_t)768 * 16384 * 4);
constexpr size_t WS_END_A = WS_ST + al4k((size_t)768 * 16384 * 2);
constexpr size_t WS_H = WS_TMP;
constexpr size_t WS_QD = WS_TMP, WS_KD = WS_QD + SZ_HT, WS_VDT = WS_KD + SZ_HT;
constexpr size_t WS_NEED = WS_END_A;
static_assert(WS_H + (size_t)TT * FF * 2 <= WS_END_A, "H fits in the overlay");

struct Params {
    const float* in[19];
    float* out;
    unsigned char* ws;
};
enum { I_XP = 0, I_XS, I_MEM, I_CMKV, I_STATE, I_CW1, I_CW2, I_CW3, I_WINA, I_WINB, I_WOUT, I_WKV, I_WMKV, I_LMG, I_LMB, I_LFG, I_LFB, I_WFIN, I_WFOUT };

DI unsigned f2bf(float f) { unsigned u = __float_as_uint(f); return (u + 0x7fffu + ((u >> 16) & 1u)) >> 16; }
DI unsigned pk2(float lo, float hi) { return f2bf(lo) | (f2bf(hi) << 16); }
DI float bf2f(unsigned h) { return __uint_as_float(h << 16); }
DI float silu_f(float x) { return __fdividef(x, 1.f + __expf(-x)); }
DI float lg2_of(int h) {
    return h == 0 ? -0.04580368961312479f : h == 1 ? -0.02272007650008353f : h == 2 ? -0.011315313227834146f : h == 3 ? -0.005646563141142063f : h == 4 ? -0.0028205190623786626f : -0.0014095702546713536f;
}
DI float wave_sum(float v) {
#pragma unroll
    for (int o = 1; o < 64; o <<= 1) v += __shfl_xor(v, o);
    return v;
}
DI float wave_max(float v) {
#pragma unroll
    for (int o = 1; o < 64; o <<= 1) v = fmaxf(v, __shfl_xor(v, o));
    return v;
}
#define MFMA16(a, b, c) __builtin_amdgcn_mfma_f32_16x16x32_bf16((a), (b), (c), 0, 0, 0)

using pg8::Unit;
typedef f32x4 AccT[2][2][4][2];

struct EpiInA {
    static constexpr bool PERM = true, AFTER_DRAIN = false;
    bf16 *Q, *K, *V, *G, *QM, *KDT, *VT; const float* rope;
    DI void operator()(const AccT& acc, const Unit& u, int wr, int wc, int fr, int fq) const {
        const int pn = u.pn, seg = pn / 3, pr = pn - seg * 3;
        const bool prompt = u.pm < 64;
        const int row0 = u.pm * 256 + wr * 64 + fr;
#pragma unroll
        for (int ai = 0; ai < 2; ++ai)
#pragma unroll
        for (int m = 0; m < 4; ++m) {
            const int row = row0 + ai * 128 + m * 16;
            const int b = row >> 13, s = row & 8191;
            const int pos = prompt ? s : 8192 + ((row - TP) & 7);
#pragma unroll
            for (int bj = 0; bj < 2; ++bj) {
                const f32x4 v0 = acc[ai][bj][m][0], v1 = acc[ai][bj][m][1];
                if (seg < 2) {
                    const int h = 2 * pr + bj, uu = 4 * wc + fq;
                    const f32x4* rp = (const f32x4*)(rope + ((size_t)pos * 64 + 4 * uu) * 2);
                    const f32x4 r0 = rp[0], r1 = rp[1];
                    const float sc = seg == 1 ? 0.08838834764831845f : 1.f;
                    float o1[4], o2[4];
                    o1[0] = (v0[0] * r0[0] - v1[0] * r0[1]) * sc; o2[0] = (v1[0] * r0[0] + v0[0] * r0[1]) * sc;
                    o1[1] = (v0[1] * r0[2] - v1[1] * r0[3]) * sc; o2[1] = (v1[1] * r0[2] + v0[1] * r0[3]) * sc;
                    o1[2] = (v0[2] * r1[0] - v1[2] * r1[1]) * sc; o2[2] = (v1[2] * r1[0] + v0[2] * r1[1]) * sc;
                    o1[3] = (v0[3] * r1[2] - v1[3] * r1[3]) * sc; o2[3] = (v1[3] * r1[2] + v0[3] * r1[3]) * sc;
                    bf16* dst = (seg == 0 ? Q : K) + (size_t)row * 768 + h * 128 + 4 * uu;
                    *(u32x2*)dst = (u32x2){pg8::cvt_pk_bf16(o1[0], o1[1]), pg8::cvt_pk_bf16(o1[2], o1[3])};
                    *(u32x2*)(dst + 64) = (u32x2){pg8::cvt_pk_bf16(o2[0], o2[1]), pg8::cvt_pk_bf16(o2[2], o2[3])};
                    if (seg == 1 && prompt) {
                        const float dec = exp2f((float)(127 - (s & 127)) * lg2_of(h));
                        bf16* kd = KDT + ((size_t)(b * 6 + h) * 128 + 4 * uu) * 8192 + s;
#pragma unroll
                        for (int j = 0; j < 4; ++j) { kd[(size_t)j * 8192] = (bf16)f2bf(o1[j] * dec); kd[(size_t)(64 + j) * 8192] = (bf16)f2bf(o2[j] * dec); }
                    }
                } else if (seg == 2) {
                    const int h = 2 * pr + bj, dv0 = 32 * wc + 8 * fq;
                    *(u32x4*)(V + (size_t)row * 768 + h * 128 + dv0) = (u32x4){pg8::cvt_pk_bf16(v0[0], v0[1]), pg8::cvt_pk_bf16(v0[2], v0[3]), pg8::cvt_pk_bf16(v1[0], v1[1]), pg8::cvt_pk_bf16(v1[2], v1[3])};
                    if (prompt) {
                        bf16* vt = VT + ((size_t)(b * 6 + h) * 128 + dv0) * 8192 + s;
#pragma unroll
                        for (int j = 0; j < 4; ++j) { vt[(size_t)j * 8192] = (bf16)f2bf(v0[j]); vt[(size_t)(4 + j) * 8192] = (bf16)f2bf(v1[j]); }
                    }
                } else if (seg == 3) {
                    const int c = pr * 256 + bj * 128 + 32 * wc + 8 * fq;
                    *(u32x4*)(G + (size_t)row * 768 + c) = (u32x4){pg8::cvt_pk_bf16(silu_f(v0[0]), silu_f(v0[1])), pg8::cvt_pk_bf16(silu_f(v0[2]), silu_f(v0[3])),
                                                                   pg8::cvt_pk_bf16(silu_f(v1[0]), silu_f(v1[1])), pg8::cvt_pk_bf16(silu_f(v1[2]), silu_f(v1[3]))};
                } else {
                    const int c = bj * 128 + 32 * wc + 8 * fq;
                    *(u32x4*)(QM + (size_t)row * 256 + c) = (u32x4){pg8::cvt_pk_bf16(v0[0] * 0.125f, v0[1] * 0.125f), pg8::cvt_pk_bf16(v0[2] * 0.125f, v0[3] * 0.125f),
                                                                    pg8::cvt_pk_bf16(v1[0] * 0.125f, v1[1] * 0.125f), pg8::cvt_pk_bf16(v1[2] * 0.125f, v1[3] * 0.125f)};
                }
            }
        }
    }
};

struct EpiMemKV {
    static constexpr bool PERM = true, AFTER_DRAIN = false;
    float* out32; bf16* MK; bf16* MVT;
    DI void operator()(const AccT& acc, const Unit& u, int wr, int wc, int fr, int fq) const {
        const int b = u.pm;
#pragma unroll
        for (int ai = 0; ai < 2; ++ai)
#pragma unroll
        for (int m = 0; m < 4; ++m) {
            const int n = ai * 128 + wr * 64 + m * 16 + fr;
#pragma unroll
            for (int bj = 0; bj < 2; ++bj) {
                const f32x4 v0 = acc[ai][bj][m][0], v1 = acc[ai][bj][m][1];
                const int cl = bj * 128 + 32 * wc + 8 * fq;
                float* o = out32 + (size_t)(b * 256 + n) * 512 + u.pn * 256 + cl;
                *(f32x4*)o = v0; *(f32x4*)(o + 4) = v1;
                const int h = cl >> 6, d0 = cl & 63;
                if (u.pn == 0) {
                    *(u32x4*)(MK + ((size_t)(b * 4 + h) * 256 + n) * 64 + d0) = (u32x4){pg8::cvt_pk_bf16(v0[0], v0[1]), pg8::cvt_pk_bf16(v0[2], v0[3]), pg8::cvt_pk_bf16(v1[0], v1[1]), pg8::cvt_pk_bf16(v1[2], v1[3])};
                } else {
                    bf16* vt = MVT + ((size_t)(b * 4 + h) * 64 + d0) * 256 + n;
#pragma unroll
                    for (int j = 0; j < 4; ++j) { vt[j * 256] = (bf16)f2bf(v0[j]); vt[(4 + j) * 256] = (bf16)f2bf(v1[j]); }
                }
            }
        }
    }
};

struct EpiPre {
    static constexpr bool PERM = true, AFTER_DRAIN = false;
    const float* res0; const float* res1; float* out;
    DI void operator()(const AccT& acc, const Unit& u, int wr, int wc, int fr, int fq) const {
        const int row0 = u.pm * 256 + wr * 64 + fr;
        const float* rb = u.pm < 64 ? res0 : res1 - (size_t)TP * DM;
#pragma unroll
        for (int ai = 0; ai < 2; ++ai)
#pragma unroll
        for (int m = 0; m < 4; ++m) {
            const int row = row0 + ai * 128 + m * 16;
#pragma unroll
            for (int bj = 0; bj < 2; ++bj) {
                const size_t off = (size_t)row * DM + u.pn * 256 + bj * 128 + 32 * wc + 8 * fq;
                const f32x4 ra = *(const f32x4*)(rb + off), rc = *(const f32x4*)(rb + off + 4);
                *(f32x4*)(out + off) = ra * ALPHA + acc[ai][bj][m][0];
                *(f32x4*)(out + off + 4) = rc * ALPHA + acc[ai][bj][m][1];
            }
        }
    }
};

struct EpiFfnIn {
    static constexpr bool PERM = true, AFTER_DRAIN = false;
    bf16* H;
    DI void operator()(const AccT& acc, const Unit& u, int wr, int wc, int fr, int fq) const {
        const int row0 = u.pm * 256 + wr * 64 + fr;
#pragma unroll
        for (int ai = 0; ai < 2; ++ai)
#pragma unroll
        for (int m = 0; m < 4; ++m) {
            const int row = row0 + ai * 128 + m * 16;
#pragma unroll
            for (int bj = 0; bj < 2; ++bj) {
                const f32x4 g = acc[ai][bj][m][0], up = acc[ai][bj][m][1];
                bf16* dst = H + (size_t)row * FF + u.pn * 128 + bj * 64 + 16 * wc + 4 * fq;
                *(u32x2*)dst = (u32x2){pg8::cvt_pk_bf16(silu_f(g[0]) * up[0], silu_f(g[1]) * up[1]), pg8::cvt_pk_bf16(silu_f(g[2]) * up[2], silu_f(g[3]) * up[3])};
            }
        }
    }
};

struct EpiKVB {
    static constexpr bool PERM = true, AFTER_DRAIN = false;
    float* out; bf16 *QD, *KD, *VDT, *QM; float* QDS; const float* rope;
    DI void operator()(const AccT& acc, const Unit& u, int wr, int wc, int fr, int fq) const {
        const int pn = u.pn, seg = pn / 3, pr = pn - seg * 3;
        const bool prompt = u.pm < 64;
        const int row0 = u.pm * 256 + wr * 64 + fr;
#pragma unroll
        for (int ai = 0; ai < 2; ++ai)
#pragma unroll
        for (int m = 0; m < 4; ++m) {
            const int row = row0 + ai * 128 + m * 16;
            const int b = prompt ? (row >> 13) : ((row - TP) >> 3), s = row & 8191, t = (row - TP) & 7;
            const int pos = prompt ? s : 8192 + t;
#pragma unroll
            for (int bj = 0; bj < 2; ++bj) {
                const f32x4 v0 = acc[ai][bj][m][0], v1 = acc[ai][bj][m][1];
                if (seg == 3) {
                    const int c = bj * 128 + 32 * wc + 8 * fq;
                    *(u32x4*)(QM + (size_t)row * 256 + c) = (u32x4){pg8::cvt_pk_bf16(v0[0] * 0.125f, v0[1] * 0.125f), pg8::cvt_pk_bf16(v0[2] * 0.125f, v0[3] * 0.125f),
                                                                    pg8::cvt_pk_bf16(v1[0] * 0.125f, v1[1] * 0.125f), pg8::cvt_pk_bf16(v1[2] * 0.125f, v1[3] * 0.125f)};
                    continue;
                }
                const int hh = 4 * pr + 2 * bj + (wc >> 1), g = hh >> 2, hg = hh & 3, sh = 2 * g, W = 128 << sh;
                const int tau = ((s & ((1 << sh) - 1)) << (13 - sh)) + (s >> sh);
                float* wrow = nullptr;
                if (prompt) { if (s >= 8192 - W) wrow = out + o_winp(g) + ((size_t)b * W + (s - (8192 - W))) * 512 + hg * 64; }
                else wrow = out + o_wins(g) + ((size_t)b * W + (W - 8 + t)) * 512 + hg * 64;
                if (seg == 1) {
                    const int d0 = 32 * (wc & 1) + 8 * fq;
                    if (wrow) { *(f32x4*)(wrow + 256 + d0) = v0; *(f32x4*)(wrow + 256 + d0 + 4) = v1; }
                    if (prompt) {
                        bf16* vt = VDT + ((size_t)(b * 12 + hh) * 64 + d0) * 8192 + tau;
#pragma unroll
                        for (int j = 0; j < 4; ++j) { vt[(size_t)j * 8192] = (bf16)f2bf(v0[j]); vt[(size_t)(4 + j) * 8192] = (bf16)f2bf(v1[j]); }
                    }
                } else {
                    const int u8 = 4 * (wc & 1) + fq;
                    const f32x2* rp = (const f32x2*)rope + (size_t)pos * 64 + 8 * u8;
                    const float sc = seg == 2 ? 0.125f : 1.f;
                    f32x4 o1, o2;
#pragma unroll
                    for (int j = 0; j < 4; ++j) { const f32x2 cs = rp[2 * j]; o1[j] = (v0[j] * cs[0] - v1[j] * cs[1]) * sc; o2[j] = (v1[j] * cs[0] + v0[j] * cs[1]) * sc; }
                    if (seg == 0) {
                        if (wrow) { *(f32x4*)(wrow + 4 * u8) = o1; *(f32x4*)(wrow + 32 + 4 * u8) = o2; }
                        if (prompt) {
                            bf16* kd = KD + ((size_t)(b * 12 + hh) * 8192 + tau) * 64 + 4 * u8;
                            *(u32x2*)kd = (u32x2){pg8::cvt_pk_bf16(o1[0], o1[1]), pg8::cvt_pk_bf16(o1[2], o1[3])};
                            *(u32x2*)(kd + 32) = (u32x2){pg8::cvt_pk_bf16(o2[0], o2[1]), pg8::cvt_pk_bf16(o2[2], o2[3])};
                        }
                    } else {
                        if (prompt) {
                            bf16* qd = QD + ((size_t)(b * 12 + hh) * 8192 + tau) * 64 + 4 * u8;
                            *(u32x2*)qd = (u32x2){pg8::cvt_pk_bf16(o1[0], o1[1]), pg8::cvt_pk_bf16(o1[2], o1[3])};
                            *(u32x2*)(qd + 32) = (u32x2){pg8::cvt_pk_bf16(o2[0], o2[1]), pg8::cvt_pk_bf16(o2[2], o2[3])};
                        } else {
                            float* qs = QDS + (size_t)(row - TP) * 768 + hh * 64 + 4 * u8;
                            *(f32x4*)qs = o1; *(f32x4*)(qs + 32) = o2;
                        }
                    }
                }
            }
        }
    }
};

template <int MAP> DI int map_row(int n) {
    if (MAP == 1) {
        if (n < 1536) { const int hs = n >> 7, i = n & 127; const int g = (i < 64) ? (8 * (i >> 2) + (i & 3)) : (8 * ((i - 64) >> 2) + 4 + (i & 3)); return hs * 128 + g; }
        return n;
    } else if (MAP == 2) {
        const int type = n >= FF ? 1 : 0, j = n - type * FF, pn = j >> 7, jj = j & 127;
        return 256 * pn + 8 * (jj >> 2) + 4 * type + (jj & 3);
    } else if (MAP == 3) {
        if (n < 768) { const int hd = n >> 6, i = n & 63; const int g = (i < 32) ? (8 * (i >> 2) + (i & 3)) : (8 * ((i - 32) >> 2) + 4 + (i & 3)); return hd * 64 + g; }
        return n;
    }
    return n;
}
template <int MAP> DI void transpose_item(const float* W, int K, int N, bf16* WT, int row_off, LAS float* scr, int item, int lane) {
    const int nblk = N / 32, kb = item / nblk, nb = item % nblk, k0 = 64 * kb, n0 = 32 * nb;
#pragma unroll 8
    for (int i = 0; i < 32; ++i) { const int kk = 2 * i + (lane >> 5); scr[kk * 33 + (lane & 31)] = W[(size_t)(k0 + kk) * N + n0 + (lane & 31)]; }
    asm volatile("s_waitcnt lgkmcnt(0)" ::: "memory");
    const int c = lane & 7;
#pragma unroll
    for (int j = 0; j < 4; ++j) { const int n = (lane >> 3) + 8 * j; const LAS float* s = scr + (8 * c) * 33 + n;
        u32x4 o; o.x = pk2(s[0 * 33], s[1 * 33]); o.y = pk2(s[2 * 33], s[3 * 33]); o.z = pk2(s[4 * 33], s[5 * 33]); o.w = pk2(s[6 * 33], s[7 * 33]);
        *(u32x4*)(WT + (size_t)(row_off + map_row<MAP>(n0 + n)) * K + k0 + 8 * c) = o; }
    asm volatile("s_waitcnt lgkmcnt(0)" ::: "memory");
}

DI void phase_prologue(const Params& p, LAS unsigned char* lds) {
    const int tid = threadIdx.x, lane = tid & 63, wave = __builtin_amdgcn_readfirstlane(tid >> 6);
    const int gw = blockIdx.x * 8 + wave, NGW = gridDim.x * 8;
    const size_t gt = (size_t)blockIdx.x * NTHR + tid, NGT = (size_t)gridDim.x * NTHR;
    unsigned char* ws = p.ws;
    LAS float* scr = (LAS float*)(lds + wave * 16384);
    constexpr int I_A = 16 * (N_INA / 32), I_B = 16 * 32, I_O = 16 * 32, I_KV = 16 * 48, I_MK = 16 * 16, I_FI = 16 * (N_FFIN / 32), I_FO = (FF / 64) * 32;
    constexpr int NIT = I_A + I_B + 2 * I_O + I_KV + 2 * I_MK + 2 * I_FI + 2 * I_FO;
    for (int it = gw; it < NIT; it += NGW) {
        int r = it;
        if (r < I_A) { transpose_item<1>(p.in[I_WINA], DM, N_INA, (bf16*)(ws + WS_WINA), 0, scr, r, lane); continue; } r -= I_A;
        if (r < I_B) { transpose_item<3>(p.in[I_WINB], DM, 1024, (bf16*)(ws + WS_WKVB), 1536, scr, r, lane); continue; } r -= I_B;
        if (r < 2 * I_O) { const int l = r / I_O; transpose_item<0>(p.in[I_WOUT] + (size_t)l * DM * DM, DM, DM, (bf16*)(ws + WS_WOUT) + (size_t)l * DM * DM, 0, scr, r % I_O, lane); continue; } r -= 2 * I_O;
        if (r < I_KV) { transpose_item<3>(p.in[I_WKV], DM, 1536, (bf16*)(ws + WS_WKVB), 0, scr, r, lane); continue; } r -= I_KV;
        if (r < 2 * I_MK) { const int l = r / I_MK; transpose_item<0>(p.in[I_WMKV] + (size_t)l * DM * 512, DM, 512, (bf16*)(ws + WS_WMKV) + (size_t)l * 512 * DM, 0, scr, r % I_MK, lane); continue; } r -= 2 * I_MK;
        if (r < 2 * I_FI) { const int l = r / I_FI; transpose_item<2>(p.in[I_WFIN] + (size_t)l * DM * N_FFIN, DM, N_FFIN, (bf16*)(ws + WS_WFIN) + (size_t)l * N_FFIN * DM, 0, scr, r % I_FI, lane); continue; } r -= 2 * I_FI;
        { const int l = r / I_FO; transpose_item<0>(p.in[I_WFOUT] + (size_t)l * FF * DM, FF, DM, (bf16*)(ws + WS_WFOUT) + (size_t)l * DM * FF, 0, scr, r % I_FO, lane); }
    }
    {
        bf16* XB = (bf16*)(ws + WS_XB);
        const size_t n8 = (size_t)TT * DM / 8, np8 = (size_t)TP * DM / 8;
        for (size_t i = gt; i < n8; i += NGT) {
            const float* src = i < np8 ? p.in[I_XP] + i * 8 : p.in[I_XS] + (i - np8) * 8;
            const f32x4 a = *(const f32x4*)src, b = *(const f32x4*)(src + 4);
            *(u32x4*)(XB + i * 8) = (u32x4){pk2(a[0], a[1]), pk2(a[2], a[3]), pk2(b[0], b[1]), pk2(b[2], b[3])};
        }
        bf16* MB = (bf16*)(ws + WS_MEMB);
        for (size_t i = gt; i < (size_t)512 * DM / 8; i += NGT) {
            const float* src = p.in[I_MEM] + i * 8;
            const f32x4 a = *(const f32x4*)src, b = *(const f32x4*)(src + 4);
            *(u32x4*)(MB + i * 8) = (u32x4){pk2(a[0], a[1]), pk2(a[2], a[3]), pk2(b[0], b[1]), pk2(b[2], b[3])};
        }
    }
    {
        f32x2* R = (f32x2*)(ws + WS_ROPE);
        for (size_t i = gt; i < (size_t)8200 * 64; i += NGT) {
            const int pos = (int)(i >> 6), fi = (int)(i & 63);
            const double inv = exp(-(double)fi * (9.210340371976184 / 64.0));
            double rev = (double)pos * inv * 0.15915494309189535;
            rev -= floor(rev + 0.5);
            const float r = (float)rev;
            R[i] = (f32x2){__builtin_amdgcn_cosf(r), __builtin_amdgcn_sinf(r)};
        }
    }
#pragma unroll
    for (int g = 0; g < 3; ++g) {
        const int W = 128 << (2 * g);
        const size_t per_b = (size_t)(W - 8) * 128;
        const f32x4* src = (const f32x4*)p.in[I_CW1 + g];
        f32x4* dst = (f32x4*)(p.out + o_wins(g));
        for (size_t i = gt; i < 32 * per_b; i += NGT) {
            const size_t b = i / per_b, r = i - b * per_b;
            dst[b * (size_t)W * 128 + r] = src[b * (size_t)W * 128 + 8 * 128 + r];
        }
    }
}

DI void phase_ln(const float* x, const float* g, const float* bta, float* o32, bf16* ob) {
    const int lane = threadIdx.x & 63, gw = blockIdx.x * 8 + __builtin_amdgcn_readfirstlane(threadIdx.x >> 6), NGW = gridDim.x * 8;
    f32x4 gv[4], bv[4];
#pragma unroll
    for (int j = 0; j < 4; ++j) { gv[j] = *((const f32x4*)g + lane + 64 * j); bv[j] = *((const f32x4*)bta + lane + 64 * j); }
    for (int row = gw; row < TT; row += NGW) {
        const f32x4* xr = (const f32x4*)(x + (size_t)row * DM) + lane;
        f32x4 v[4]; float s = 0.f;
#pragma unroll
        for (int j = 0; j < 4; ++j) { v[j] = xr[64 * j]; s += (v[j][0] + v[j][1]) + (v[j][2] + v[j][3]); }
        const float mean = wave_sum(s) * (1.f / DM); float s2 = 0.f;
#pragma unroll
        for (int j = 0; j < 4; ++j) { v[j] = v[j] - mean; s2 += (v[j][0] * v[j][0] + v[j][1] * v[j][1]) + (v[j][2] * v[j][2] + v[j][3] * v[j][3]); }
        const float rstd = rsqrtf(wave_sum(s2) * (1.f / DM) + LN_EPS);
        f32x4* o = (f32x4*)(o32 + (size_t)row * DM) + lane;
#pragma unroll
        for (int j = 0; j < 4; ++j) {
            const f32x4 y = v[j] * rstd * gv[j] + bv[j];
            o[64 * j] = y;
            if (ob) *(u32x2*)(ob + (size_t)row * DM + (lane + 64 * j) * 4) = (u32x2){pk2(y[0], y[1]), pk2(y[2], y[3])};
        }
    }
}

template <int CSH> DI void stage_rows(LAS unsigned char* dst, int ls, const bf16* src, size_t gs, int nrows) {
    const int total = nrows << CSH;
    for (int i = threadIdx.x; i < total; i += NTHR) {
        const int r = i >> CSH, c = i & ((1 << CSH) - 1);
        *(LAS u32x4*)(dst + r * ls + c * 16) = *(const u32x4*)(src + (size_t)r * gs + c * 8);
    }
}
template <int CSH> DI void zero_rows(LAS unsigned char* dst, int ls, int nrows) {
    const int total = nrows << CSH;
    for (int i = threadIdx.x; i < total; i += NTHR) { const int r = i >> CSH, c = i & ((1 << CSH) - 1); *(LAS u32x4*)(dst + r * ls + c * 16) = (u32x4){0u, 0u, 0u, 0u}; }
}
DI bf16x8 lds_frag(const LAS unsigned char* base, int ls, int row, int col) { return *(const LAS bf16x8*)(base + row * ls + col * 2); }
DI bf16x8 lds_frag2(const LAS unsigned char* base, int ls, int row, int c0, int c1) {
    const s16x4 a = *(const LAS s16x4*)(base + row * ls + c0 * 2), b = *(const LAS s16x4*)(base + row * ls + c1 * 2);
    return (bf16x8){a[0], a[1], a[2], a[3], b[0], b[1], b[2], b[3]};
}
DI bf16x8 pack8(const f32x4& a, const f32x4& b) {
    const u32x4 w = (u32x4){pk2(a[0], a[1]), pk2(a[2], a[3]), pk2(b[0], b[1]), pk2(b[2], b[3])};
    return __builtin_bit_cast(bf16x8, w);
}

constexpr int LS128 = 272, LS64 = 144, LS256 = 528;
DI void ret_u_item(const Params& p, LAS unsigned char* lds, int item) {
    const int bh = item >> 6, c = item & 63;
    const int lane = threadIdx.x & 63, w = __builtin_amdgcn_readfirstlane(threadIdx.x >> 6), fr = lane & 15, fq = lane >> 4;
    const bf16* KDT = (const bf16*)(p.ws + WS_KDT) + (size_t)bh * 128 * 8192 + c * 128;
    const bf16* VT = (const bf16*)(p.ws + WS_VT) + (size_t)bh * 128 * 8192 + c * 128;
    LAS unsigned char* sX = lds; LAS unsigned char* sY = lds + 128 * LS128;
    stage_rows<4>(sX, LS128, KDT, 8192, 128);
    stage_rows<4>(sY, LS128, VT, 8192, 128);
    __syncthreads();
    bf16x8 yf[4];
#pragma unroll
    for (int kk = 0; kk < 4; ++kk) yf[kk] = lds_frag(sY, LS128, 16 * w + fr, 32 * kk + 8 * fq);
    float* U = (float*)(p.ws + WS_U) + (size_t)item * 16384 + (size_t)(16 * w + fr) * 128;
#pragma unroll
    for (int xb = 0; xb < 8; ++xb) {
        f32x4 a = (f32x4){0.f, 0.f, 0.f, 0.f};
#pragma unroll
        for (int kk = 0; kk < 4; ++kk) a = MFMA16(lds_frag(sX, LS128, 16 * xb + fr, 32 * kk + 8 * fq), yf[kk], a);
        *(f32x4*)(U + 16 * xb + 4 * fq) = a;
    }
    __syncthreads();
}

DI void phase_scan(const Params& p) {
    const size_t gt = (size_t)blockIdx.x * NTHR + threadIdx.x, NGT = (size_t)gridDim.x * NTHR;
    const float* U = (const float*)(p.ws + WS_U);
    bf16* ST = (bf16*)(p.ws + WS_ST);
    float* outst = p.out + O_STP;
    for (size_t e = gt; e < (size_t)12 * 8192; e += NGT) {
        const int bh = (int)(e >> 13), vd = (int)(e & 8191) * 2, h = bh % 6;
        const float gc = exp2f(128.f * lg2_of(h));
        float s0 = 0.f, s1 = 0.f;
        const size_t base = (size_t)bh * 64 * 16384 + vd;
        for (int c0 = 0; c0 < 64; c0 += 8) {
            f32x2 uv[8];
#pragma unroll
            for (int k = 0; k < 8; ++k) uv[k] = *(const f32x2*)(U + base + (size_t)(c0 + k) * 16384);
#pragma unroll
            for (int k = 0; k < 8; ++k) {
                *(unsigned*)(ST + base + (size_t)(c0 + k) * 16384) = pk2(s0, s1);
                s0 = gc * s0 + uv[k][0]; s1 = gc * s1 + uv[k][1];
            }
        }
        const int v = vd >> 7, d = vd & 127;
        outst[(size_t)bh * 16384 + (size_t)d * 128 + v] = s0;
        outst[(size_t)bh * 16384 + (size_t)(d + 1) * 128 + v] = s1;
    }
}

DI void ret_o_item(const Params& p, LAS unsigned char* lds, int item) {
    const int bh = item >> 6, c = item & 63, b = bh / 6, h = bh - b * 6;
    const int lane = threadIdx.x & 63, w = __builtin_amdgcn_readfirstlane(threadIdx.x >> 6), fr = lane & 15, fq = lane >> 4;
    const size_t tok0 = (size_t)b * 8192 + c * 128;
    LAS unsigned char* sQ = lds; LAS unsigned char* sK = lds + 128 * LS128; LAS unsigned char* sV = lds + 2 * 128 * LS128; LAS unsigned char* sS = lds + 3 * 128 * LS128;
    stage_rows<4>(sQ, LS128, (const bf16*)(p.ws + WS_Q) + tok0 * 768 + h * 128, 768, 128);
    stage_rows<4>(sK, LS128, (const bf16*)(p.ws + WS_K) + tok0 * 768 + h * 128, 768, 128);
    stage_rows<4>(sV, LS128, (const bf16*)(p.ws + WS_VT) + (size_t)bh * 128 * 8192 + c * 128, 8192, 128);
    stage_rows<4>(sS, LS128, (const bf16*)(p.ws + WS_ST) + (size_t)item * 16384, 128, 128);
    __syncthreads();
    const float lg = lg2_of(h);
    const int qi = 16 * w + fr;
    bf16x8 qf[4];
#pragma unroll
    for (int kk = 0; kk < 4; ++kk) qf[kk] = lds_frag(sQ, LS128, qi, 32 * kk + 8 * fq);
    f32x4 o[8];
    const float cs = exp2f((float)(qi + 1) * lg);
#pragma unroll
    for (int db = 0; db < 8; ++db) {
        f32x4 a = (f32x4){0.f, 0.f, 0.f, 0.f};
#pragma unroll
        for (int kk = 0; kk < 4; ++kk) a = MFMA16(lds_frag(sS, LS128, 16 * db + fr, 32 * kk + 8 * fq), qf[kk], a);
        o[db] = a * cs;
    }
    f32x4 pr[8];
#pragma unroll
    for (int nb = 0; nb < 8; ++nb) {
        pr[nb] = (f32x4){0.f, 0.f, 0.f, 0.f};
        if (nb <= w) {
            f32x4 a = (f32x4){0.f, 0.f, 0.f, 0.f};
#pragma unroll
            for (int kk = 0; kk < 4; ++kk) a = MFMA16(lds_frag(sK, LS128, 16 * nb + fr, 32 * kk + 8 * fq), qf[kk], a);
#pragma unroll
            for (int j = 0; j < 4; ++j) { const int dlt = qi - (16 * nb + 4 * fq + j); pr[nb][j] = dlt >= 0 ? a[j] * exp2f((float)dlt * lg) : 0.f; }
        }
    }
#pragma unroll
    for (int k2 = 0; k2 < 4; ++k2) {
        if (2 * k2 <= w) {
            const bf16x8 pf = pack8(pr[2 * k2], pr[2 * k2 + 1]);
#pragma unroll
            for (int db = 0; db < 8; ++db) o[db] = MFMA16(lds_frag2(sV, LS128, 16 * db + fr, 32 * k2 + 4 * fq, 32 * k2 + 16 + 4 * fq), pf, o[db]);
        }
    }
    float s = 0.f;
#pragma unroll
    for (int db = 0; db < 8; ++db) s += (o[db][0] + o[db][1]) + (o[db][2] + o[db][3]);
    s += __shfl_xor(s, 16); s += __shfl_xor(s, 32);
    const float mu = s * (1.f / 128.f);
    float q2 = 0.f;
#pragma unroll
    for (int db = 0; db < 8; ++db) { o[db] = o[db] - mu; q2 += (o[db][0] * o[db][0] + o[db][1] * o[db][1]) + (o[db][2] * o[db][2] + o[db][3] * o[db][3]); }
    q2 += __shfl_xor(q2, 16); q2 += __shfl_xor(q2, 32);
    const float rstd = rsqrtf(q2 * (1.f / 128.f) + LN_EPS);
    const bf16* G = (const bf16*)(p.ws + WS_G) + (tok0 + qi) * 768 + h * 128;
    bf16* MIX = (bf16*)(p.ws + WS_MIX) + (tok0 + qi) * 1024 + h * 128;
#pragma unroll
    for (int db = 0; db < 8; ++db) {
        const u32x2 gv = *(const u32x2*)(G + 16 * db + 4 * fq);
        const float g0 = bf2f(gv[0] & 0xffffu), g1 = bf2f(gv[0] >> 16), g2 = bf2f(gv[1] & 0xffffu), g3 = bf2f(gv[1] >> 16);
        *(u32x2*)(MIX + 16 * db + 4 * fq) = (u32x2){pk2(o[db][0] * rstd * g0, o[db][1] * rstd * g1), pk2(o[db][2] * rstd * g2, o[db][3] * rstd * g3)};
    }
    __syncthreads();
}

DI void ret_sample_item(const Params& p, LAS unsigned char* lds, int item) {
    const int b = item / 6, h = item - b * 6, tid = threadIdx.x;
    LAS float* sq = (LAS float*)lds; LAS float* sk = sq + 1024; LAS float* sv = sk + 1024; LAS float* sA = sv + 1024; LAS float* sO = sA + 64;
    const size_t row0 = (size_t)TP + b * 8;
    const float lg = lg2_of(h);
    for (int i = tid; i < 1024; i += NTHR) {
        const int t = i >> 7, d = i & 127; const size_t off = (row0 + t) * 768 + h * 128 + d;
        sq[i] = bf2f(((const bf16*)(p.ws + WS_Q))[off]); sk[i] = bf2f(((const bf16*)(p.ws + WS_K))[off]); sv[i] = bf2f(((const bf16*)(p.ws + WS_V))[off]);
    }
    __syncthreads();
    if (tid < 64) {
        const int t = tid >> 3, t2 = tid & 7; float a = 0.f;
        if (t2 <= t) { for (int d = 0; d < 128; ++d) a += sq[t * 128 + d] * sk[t2 * 128 + d]; a *= exp2f((float)(t - t2) * lg); }
        sA[tid] = a;
    }
    const int v = tid & 127, dq = tid >> 7;
    const float* S = p.in[I_STATE] + (size_t)item * 16384;
    float* So = p.out + O_STS + (size_t)item * 16384;
    float cr[8];
#pragma unroll
    for (int t = 0; t < 8; ++t) cr[t] = 0.f;
    const float g8 = exp2f(8.f * lg);
    float kdec[8];
#pragma unroll
    for (int t = 0; t < 8; ++t) kdec[t] = exp2f((float)(7 - t) * lg) * sv[t * 128 + v];
    for (int i = 0; i < 32; ++i) {
        const int d = dq + 4 * i;
        const float sdv = S[(size_t)d * 128 + v];
        float ns = g8 * sdv;
#pragma unroll
        for (int t = 0; t < 8; ++t) { cr[t] += sq[t * 128 + d] * sdv; ns += sk[t * 128 + d] * kdec[t]; }
        So[(size_t)d * 128 + v] = ns;
    }
#pragma unroll
    for (int t = 0; t < 8; ++t) sO[(dq * 8 + t) * 128 + v] = cr[t];
    __syncthreads();
    {
        const int t = __builtin_amdgcn_readfirstlane(tid >> 6), lane = tid & 63;
        const float cs = exp2f((float)(t + 1) * lg);
        float ov[2];
#pragma unroll
        for (int k = 0; k < 2; ++k) {
            const int vv = lane + 64 * k;
            float a = (sO[(0 * 8 + t) * 128 + vv] + sO[(1 * 8 + t) * 128 + vv]) + (sO[(2 * 8 + t) * 128 + vv] + sO[(3 * 8 + t) * 128 + vv]);
            a *= cs;
            for (int t2 = 0; t2 <= t; ++t2) a += sA[t * 8 + t2] * sv[t2 * 128 + vv];
            ov[k] = a;
        }
        const float mu = wave_sum(ov[0] + ov[1]) * (1.f / 128.f);
        const float d0 = ov[0] - mu, d1 = ov[1] - mu;
        const float rstd = rsqrtf(wave_sum(d0 * d0 + d1 * d1) * (1.f / 128.f) + LN_EPS);
        const bf16* G = (const bf16*)(p.ws + WS_G) + (row0 + t) * 768 + h * 128;
        bf16* MIX = (bf16*)(p.ws + WS_MIX) + (row0 + t) * 1024 + h * 128;
        MIX[lane] = (bf16)f2bf(d0 * rstd * bf2f(G[lane]));
        MIX[lane + 64] = (bf16)f2bf(d1 * rstd * bf2f(G[lane + 64]));
    }
    __syncthreads();
}

template <int MODE> DI void attn64_tile(LAS unsigned char* lds, const bf16* Qg, size_t qs, const bf16* Kg, const bf16* Vtg, size_t vts, bool first,
                                        float (&osc)[4][4], float& lse_out) {
    const int lane = threadIdx.x & 63, w = __builtin_amdgcn_readfirstlane(threadIdx.x >> 6), fr = lane & 15, fq = lane >> 4;
    LAS unsigned char* sQ = lds; LAS unsigned char* sK = lds + 128 * LS64; LAS unsigned char* sV = sK + 256 * LS64;
    stage_rows<3>(sQ, LS64, Qg, qs, 128);
    if (MODE == 1 && first) {
        zero_rows<3>(sK, LS64, 128);
        stage_rows<3>(sK + 128 * LS64, LS64, Kg + 128 * 64, 64, 128);
        zero_rows<4>(sV, LS256, 64);
        stage_rows<4>(sV + 256, LS256, Vtg + 128, vts, 64);
    } else {
        stage_rows<3>(sK, LS64, Kg, 64, 256);
        stage_rows<5>(sV, LS256, Vtg, vts, 64);
    }
    __syncthreads();
    const int qi = 16 * w + fr;
    bf16x8 qf[2];
#pragma unroll
    for (int kk = 0; kk < 2; ++kk) qf[kk] = lds_frag(sQ, LS64, qi, 32 * kk + 8 * fq);
    f32x4 sc[16];
    float mx = -1e30f;
#pragma unroll
    for (int nb = 0; nb < 16; ++nb) {
        sc[nb] = (f32x4){-1e30f, -1e30f, -1e30f, -1e30f};
        if (MODE == 0 || (nb >= w && nb <= w + 8)) {
            f32x4 a = (f32x4){0.f, 0.f, 0.f, 0.f};
#pragma unroll
            for (int kk = 0; kk < 2; ++kk) a = MFMA16(lds_frag(sK, LS64, 16 * nb + fr, 32 * kk + 8 * fq), qf[kk], a);
#pragma unroll
            for (int j = 0; j < 4; ++j) {
                bool ok = true;
                if (MODE == 1) { const int kj = 16 * nb + 4 * fq + j, dlt = qi + 128 - kj; ok = dlt >= 0 && dlt <= 128 && (!first || kj >= 128); }
                const float v = ok ? a[j] : -1e30f;
                sc[nb][j] = v; mx = fmaxf(mx, v);
            }
        }
    }
    mx = fmaxf(mx, __shfl_xor(mx, 16)); mx = fmaxf(mx, __shfl_xor(mx, 32));
    float l = 0.f;
#pragma unroll
    for (int nb = 0; nb < 16; ++nb)
#pragma unroll
        for (int j = 0; j < 4; ++j) { const float e = sc[nb][j] > -1e29f ? __expf(sc[nb][j] - mx) : 0.f; sc[nb][j] = e; l += e; }
    l += __shfl_xor(l, 16); l += __shfl_xor(l, 32);
    f32x4 o[4];
#pragma unroll
    for (int db = 0; db < 4; ++db) o[db] = (f32x4){0.f, 0.f, 0.f, 0.f};
#pragma unroll
    for (int k2 = 0; k2 < 8; ++k2) {
        if (MODE == 0 || (2 * k2 + 1 >= w && 2 * k2 <= w + 8)) {
            const bf16x8 pf = pack8(sc[2 * k2], sc[2 * k2 + 1]);
#pragma unroll
            for (int db = 0; db < 4; ++db) o[db] = MFMA16(lds_frag2(sV, LS256, 16 * db + fr, 32 * k2 + 4 * fq, 32 * k2 + 16 + 4 * fq), pf, o[db]);
        }
    }
    const float inv = 1.f / l;
#pragma unroll
    for (int db = 0; db < 4; ++db)
#pragma unroll
        for (int j = 0; j < 4; ++j) osc[db][j] = o[db][j] * inv;
    lse_out = mx + __logf(l);
}

DI void memattn_item(const Params& p, LAS unsigned char* lds, int layer, int item) {
    const int tt = item >> 2, h = item & 3, b = tt >> 6;
    const int lane = threadIdx.x & 63, w = __builtin_amdgcn_readfirstlane(threadIdx.x >> 6), fr = lane & 15, fq = lane >> 4;
    const bf16* Qg = (const bf16*)(p.ws + WS_QM) + (size_t)tt * 128 * 256 + h * 64;
    const bf16* Kg = (const bf16*)(p.ws + WS_MK) + ((size_t)(layer * 2 + b) * 4 + h) * 256 * 64;
    const bf16* Vt = (const bf16*)(p.ws + WS_MVT) + ((size_t)(layer * 2 + b) * 4 + h) * 64 * 256;
    float o[4][4]; float lse;
    attn64_tile<0>(lds, Qg, 256, Kg, Vt, 256, false, o, lse);
    bf16* MIX = (bf16*)(p.ws + WS_MIX) + ((size_t)tt * 128 + 16 * w + fr) * 1024 + 768 + h * 64;
#pragma unroll
    for (int db = 0; db < 4; ++db) *(u32x2*)(MIX + 16 * db + 4 * fq) = (u32x2){pk2(o[db][0], o[db][1]), pk2(o[db][2], o[db][3])};
    __syncthreads();
}

DI void dilated_item(const Params& p, LAS unsigned char* lds, int item) {
    const int bhh = item >> 6, idx = item & 63, b = bhh / 12, hh = bhh - b * 12, g = hh >> 2, sh = 2 * g;
    const int lane = threadIdx.x & 63, w = __builtin_amdgcn_readfirstlane(threadIdx.x >> 6), fr = lane & 15, fq = lane >> 4;
    const int mblk = 64 >> sh;
    const int r = idx / mblk, c = idx - r * mblk;
    const size_t tau0 = (size_t)idx * 128;
    const bf16* Qg = (const bf16*)(p.ws + WS_QD) + ((size_t)bhh * 8192 + tau0) * 64;
    const bf16* Kg = (const bf16*)(p.ws + WS_KD) + ((size_t)bhh * 8192 + tau0) * 64 - 128 * 64;
    const bf16* Vt = (const bf16*)(p.ws + WS_VDT) + (size_t)bhh * 64 * 8192 + tau0 - 128;
    float o[4][4]; float lse;
    attn64_tile<1>(lds, Qg, 64, Kg, Vt, 8192, c == 0, o, lse);
    const int qi = 16 * w + fr;
    const size_t tok = (size_t)b * 8192 + (((size_t)(c * 128 + qi)) << sh) + r;
    bf16* MIX = (bf16*)(p.ws + WS_MIX) + tok * 1024 + hh * 64;
#pragma unroll
    for (int db = 0; db < 4; ++db) *(u32x2*)(MIX + 16 * db + 4 * fq) = (u32x2){pk2(o[db][0], o[db][1]), pk2(o[db][2], o[db][3])};
    if (fq == 0) ((float*)(p.ws + WS_LSE))[tok * 12 + hh] = lse;
    __syncthreads();
}

DI void memattn_sample_item(const Params& p, LAS unsigned char* lds, int layer, int item) {
    const int b = item >> 2, h = item & 3, tid = threadIdx.x, t = __builtin_amdgcn_readfirstlane(tid >> 6), lane = tid & 63;
    LAS float* sq = (LAS float*)lds;
    LAS float* sp = sq + 512;
    const size_t row = (size_t)TP + b * 8 + t;
    sq[t * 64 + lane] = bf2f(((const bf16*)(p.ws + WS_QM))[row * 256 + h * 64 + lane]);
    __syncthreads();
    const float* KV = p.in[I_CMKV] + ((size_t)(layer * 32 + b) * 256) * 512 + h * 64;
    float s[4]; float mx = -1e30f;
#pragma unroll
    for (int i = 0; i < 4; ++i) {
        const float* kr = KV + (size_t)(lane + 64 * i) * 512; float a = 0.f;
#pragma unroll
        for (int d = 0; d < 64; d += 4) { const f32x4 kv = *(const f32x4*)(kr + d); a += (kv[0] * sq[t * 64 + d] + kv[1] * sq[t * 64 + d + 1]) + (kv[2] * sq[t * 64 + d + 2] + kv[3] * sq[t * 64 + d + 3]); }
        s[i] = a; mx = fmaxf(mx, a);
    }
    mx = wave_max(mx);
    float l = 0.f;
#pragma unroll
    for (int i = 0; i < 4; ++i) { s[i] = __expf(s[i] - mx); l += s[i]; sp[t * 256 + lane + 64 * i] = s[i]; }
    l = wave_sum(l);
    asm volatile("s_waitcnt lgkmcnt(0)" ::: "memory");
    float o = 0.f;
    for (int n = 0; n < 256; ++n) o += sp[t * 256 + n] * KV[(size_t)n * 512 + 256 + lane];
    ((bf16*)(p.ws + WS_MIX))[row * 1024 + 768 + h * 64 + lane] = (bf16)f2bf(o / l);
    __syncthreads();
}
DI void dilated_sample_item(const Params& p, LAS unsigned char* lds, int item) {
    const int b = item / 12, hh = item - b * 12, g = hh >> 2, hg = hh & 3, sh = 2 * g, W = 128 << sh, dil = 1 << sh;
    const int tid = threadIdx.x, t = __builtin_amdgcn_readfirstlane(tid >> 6), lane = tid & 63;
    LAS float* sq = (LAS float*)lds;
    LAS float* sp = sq + 512;
    const size_t rs = (size_t)b * 8 + t;
    sq[t * 64 + lane] = ((const float*)(p.ws + WS_QDS))[rs * 768 + hh * 64 + lane];
    __syncthreads();
    const float* cache = p.in[I_CW1 + g] + (size_t)b * W * 512 + hg * 64;
    const float* nw = p.out + o_wins(g) + ((size_t)b * W + (W - 8)) * 512 + hg * 64;
    float s[3]; float mx = -1e30f;
#pragma unroll
    for (int i = 0; i < 3; ++i) {
        const int j = lane + 64 * i; s[i] = -1e30f;
        if (j <= 128) {
            const int idx = W + t - dil * j;
            const float* kr = idx >= W ? nw + (size_t)(idx - W) * 512 : cache + (size_t)idx * 512;
            float a = 0.f;
#pragma unroll
            for (int d = 0; d < 64; d += 4) { const f32x4 kv = *(const f32x4*)(kr + d); a += (kv[0] * sq[t * 64 + d] + kv[1] * sq[t * 64 + d + 1]) + (kv[2] * sq[t * 64 + d + 2] + kv[3] * sq[t * 64 + d + 3]); }
            s[i] = a; mx = fmaxf(mx, a);
        }
    }
    mx = wave_max(mx);
    float l = 0.f;
#pragma unroll
    for (int i = 0; i < 3; ++i) { const int j = lane + 64 * i; if (j <= 128) { const float e = __expf(s[i] - mx); l += e; sp[t * 192 + j] = e; } }
    l = wave_sum(l);
    asm volatile("s_waitcnt lgkmcnt(0)" ::: "memory");
    float o = 0.f;
    for (int j = 0; j <= 128; ++j) {
        const int idx = W + t - dil * j;
        const float* vr = idx >= W ? nw + (size_t)(idx - W) * 512 : cache + (size_t)idx * 512;
        o += sp[t * 192 + j] * vr[256 + lane];
    }
    const size_t row = (size_t)TP + rs;
    ((bf16*)(p.ws + WS_MIX))[row * 1024 + hh * 64 + lane] = (bf16)f2bf(o / l);
    if (lane == 0) ((float*)(p.ws + WS_LSE))[row * 12 + hh] = mx + __logf(l);
    __syncthreads();
}

DI void phase_combine(const Params& p) {
    const size_t gt = (size_t)blockIdx.x * NTHR + threadIdx.x, NGT = (size_t)gridDim.x * NTHR;
    const float* LSE = (const float*)(p.ws + WS_LSE);
    bf16* MIX = (bf16*)(p.ws + WS_MIX);
    for (size_t i = gt; i < (size_t)TT * 96; i += NGT) {
        const size_t row = i / 96; const int ch = (int)(i - row * 96), hh = ch >> 3, hg = hh & 3;
        const float l0 = LSE[row * 12 + hg], l1 = LSE[row * 12 + 4 + hg], l2 = LSE[row * 12 + 8 + hg];
        const float m = fmaxf(l0, fmaxf(l1, l2));
        const float e0 = __expf(l0 - m), e1 = __expf(l1 - m), e2 = __expf(l2 - m);
        const float mine = (hh >> 2) == 0 ? e0 : ((hh >> 2) == 1 ? e1 : e2);
        const float wgt = mine / (e0 + e1 + e2);
        u32x4 v = *(u32x4*)(MIX + row * 1024 + ch * 8);
#pragma unroll
        for (int k = 0; k < 4; ++k) v[k] = pk2(bf2f(v[k] & 0xffffu) * wgt, bf2f(v[k] >> 16) * wgt);
        *(u32x4*)(MIX + row * 1024 + ch * 8) = v;
    }
}

template <class Epi> DI void run_gemm(LAS unsigned char* lds, const bf16* A, const bf16* Bt, int M, int N, int K, const Epi& E) {
    pg8::Gemm g{A, Bt, M, N, K}; pg8::StaticOrder S; S.init(M, N, (int)gridDim.x, (int)blockIdx.x);
    pg8::gemm_phase<Epi, pg8::StaticOrder, true, true>((PG8_LAS unsigned char*)lds, g, S, E);
}


#ifndef PHMASK
#define PHMASK 0x3ffff
#endif
#define IN(k) (((PHMASK >> (k)) & 1) && ph_lo <= (k) && (k) < ph_hi)
#define SEAM(k) do { if (IN(k) && IN((k) + 1)) grid.sync(); } while (0)
template <int L> DI void layer_tail(const Params& p, LAS unsigned char* lds, cg::grid_group& grid, int ph_lo, int ph_hi) {
    unsigned char* ws = p.ws;
    constexpr int pb = 5 + 8 * L;
    if (IN(pb)) {
        EpiPre E{L == 0 ? p.in[I_XP] : (const float*)(ws + WS_XR), L == 0 ? p.in[I_XS] : (const float*)(ws + WS_XR) + (size_t)TP * DM, (float*)(ws + WS_XR)};
        run_gemm(lds, (const bf16*)(ws + WS_MIX), (const bf16*)(ws + WS_WOUT) + (size_t)L * DM * DM, TT, DM, DM, E);
    }
    SEAM(pb);
    if (IN(pb + 1)) phase_ln((const float*)(ws + WS_XR), p.in[I_LMG] + L * DM, p.in[I_LMB] + L * DM, (float*)(ws + WS_XR), (bf16*)(ws + WS_XB));
    SEAM(pb + 1);
    if (IN(pb + 2)) {
        EpiFfnIn E{(bf16*)(ws + WS_H)};
        run_gemm(lds, (const bf16*)(ws + WS_XB), (const bf16*)(ws + WS_WFIN) + (size_t)L * N_FFIN * DM, TT, N_FFIN, DM, E);
    }
    SEAM(pb + 2);
    if (IN(pb + 3)) {
        EpiPre E{(const float*)(ws + WS_XR), (const float*)(ws + WS_XR) + (size_t)TP * DM, (float*)(ws + WS_XR)};
        run_gemm(lds, (const bf16*)(ws + WS_H), (const bf16*)(ws + WS_WFOUT) + (size_t)L * DM * FF, TT, DM, FF, E);
    }
    SEAM(pb + 3);
    if (IN(pb + 4)) phase_ln((const float*)(ws + WS_XR), p.in[I_LFG] + L * DM, p.in[I_LFB] + L * DM, L == 0 ? (float*)(ws + WS_XR) : p.out, L == 0 ? (bf16*)(ws + WS_XB) : nullptr);
    SEAM(pb + 4);
}
#undef IN
#undef SEAM

__global__ void __launch_bounds__(NTHR, 2) yoco_fwd(Params p, int ph_lo, int ph_hi) {
    extern __shared__ __attribute__((aligned(16))) unsigned char lds_raw[];
    LAS unsigned char* lds = (LAS unsigned char*)lds_raw;
    cg::grid_group grid = cg::this_grid();
    unsigned char* ws = p.ws;
    const int G = gridDim.x, bx = blockIdx.x;
#ifndef PHMASK
#define PHMASK 0x3ffff
#endif
#define IN(k) (((PHMASK >> (k)) & 1) && ph_lo <= (k) && (k) < ph_hi)
#define SEAM(k) do { if (IN(k) && IN((k) + 1)) grid.sync(); } while (0)

    if (IN(0)) { phase_prologue(p, lds); __syncthreads(); }
    SEAM(0);
    if (IN(1)) {
        EpiInA E{(bf16*)(ws + WS_Q), (bf16*)(ws + WS_K), (bf16*)(ws + WS_V), (bf16*)(ws + WS_G), (bf16*)(ws + WS_QM), (bf16*)(ws + WS_KDT), (bf16*)(ws + WS_VT), (const float*)(ws + WS_ROPE)};
        run_gemm(lds, (const bf16*)(ws + WS_XB), (const bf16*)(ws + WS_WINA), TT, N_INA, DM, E);
#pragma unroll 1
        for (int l = 0; l < 2; ++l) {
            EpiMemKV E2{p.out + O_MKV + (size_t)l * 512 * 512, (bf16*)(ws + WS_MK) + (size_t)l * 2 * 4 * 256 * 64, (bf16*)(ws + WS_MVT) + (size_t)l * 2 * 4 * 256 * 64};
            run_gemm(lds, (const bf16*)(ws + WS_MEMB), (const bf16*)(ws + WS_WMKV) + (size_t)l * 512 * DM, 512, 512, DM, E2);
        }
    }
    SEAM(1);
    if (IN(2)) {
        for (int it = bx; it < 768 + 512 + 128; it += G) {
            if (it < 768) ret_u_item(p, lds, it);
            else if (it < 768 + 512) memattn_item(p, lds, 0, it - 768);
            else memattn_sample_item(p, lds, 0, it - 768 - 512);
        }
    }
    SEAM(2);
    if (IN(3)) phase_scan(p);
    SEAM(3);
    if (IN(4)) {
        for (int it = bx; it < 768 + 192; it += G) {
            if (it < 768) ret_o_item(p, lds, it); else ret_sample_item(p, lds, it - 768);
        }
    }
    SEAM(4);
    layer_tail<0>(p, lds, grid, ph_lo, ph_hi);
    if (IN(10)) {
        EpiKVB E{p.out, (bf16*)(ws + WS_QD), (bf16*)(ws + WS_KD), (bf16*)(ws + WS_VDT), (bf16*)(ws + WS_QM), (float*)(ws + WS_QDS), (const float*)(ws + WS_ROPE)};
        run_gemm(lds, (const bf16*)(ws + WS_XB), (const bf16*)(ws + WS_WKVB), TT, N_KVB, DM, E);
    }
    SEAM(10);
    if (IN(11)) {
        for (int it = bx; it < 1536 + 512 + 384 + 128; it += G) {
            if (it < 1536) dilated_item(p, lds, it);
            else if (it < 1536 + 512) memattn_item(p, lds, 1, it - 1536);
            else if (it < 1536 + 512 + 384) dilated_sample_item(p, lds, it - 1536 - 512);
            else memattn_sample_item(p, lds, 1, it - 1536 - 512 - 384);
        }
    }
    SEAM(11);
    if (IN(12)) phase_combine(p);
    SEAM(12);
    layer_tail<1>(p, lds, grid, ph_lo, ph_hi);
#undef IN
#undef SEAM
}

#ifndef N_PHASES
#define N_PHASES 18
#endif
#ifndef MULTI_LAUNCH
#define MULTI_LAUNCH 0
#endif
extern "C" void kernel_launch(void* const* d_in, const int* in_sizes, int n_in, void* d_out, int out_size, void* d_ws, size_t ws_size, hipStream_t stream) {
    static int grid = 0;
    if (grid == 0) {
        if (n_in != 19 || ws_size < WS_NEED) { fprintf(stderr, "kernel_launch: need 19 inputs and %zu bytes of workspace; got %d, %zu\n", (size_t)WS_NEED, n_in, ws_size); grid = -1; return; }
        int dev = 0, cus = 0, per_cu = 0;
        hipGetDevice(&dev);
        hipDeviceGetAttribute(&cus, hipDeviceAttributeMultiprocessorCount, dev);
        if (hipFuncSetAttribute((const void*)yoco_fwd, hipFuncAttributeMaxDynamicSharedMemorySize, LDS_BYTES) != hipSuccess) { fprintf(stderr, "kernel_launch: hipFuncSetAttribute failed\n"); grid = -1; return; }
        if (hipOccupancyMaxActiveBlocksPerMultiprocessor(&per_cu, (const void*)yoco_fwd, NTHR, LDS_BYTES) != hipSuccess || per_cu < 1) { fprintf(stderr, "kernel_launch: occupancy query says %d\n", per_cu); per_cu = 1; }
        (void)hipGetLastError();
        grid = cus * per_cu;
        fprintf(stderr, "kernel_launch: grid %d (cus %d x %d)\n", grid, cus, per_cu);
    }
    if (grid < 0) return;
    Params p{};
    for (int i = 0; i < 19; ++i) p.in[i] = (const float*)d_in[i];
    p.out = (float*)d_out; p.ws = (unsigned char*)d_ws;
#if MULTI_LAUNCH
    for (int ph = 0; ph < N_PHASES; ++ph) {
        int lo = ph, hi = ph + 1;
        hipLaunchKernelGGL(yoco_fwd, dim3(grid), dim3(NTHR), LDS_BYTES, stream, p, lo, hi);
    }
#else
    int lo = 0, hi = N_PHASES;
    void* args[] = {&p, &lo, &hi};
    hipError_t e = hipLaunchCooperativeKernel((const void*)yoco_fwd, dim3(grid), dim3(NTHR), args, LDS_BYTES, stream);
    if (e != hipSuccess) fprintf(stderr, "kernel_launch: cooperative launch failed: %s (grid %d)\n", hipGetErrorString(e), grid);
#endif
}
```
